# Optimizing an MI355X kernel written in HIP

```python
import jax, jax.numpy as jnp
from jax import lax
import numpy as np

D_MODEL = 1024
BATCH = 32
SEQ = 256
DEPTH = 2
DEC_BATCH = 4
DEC_SEQ = 2048
PAST_LEN = 256

GRID_W = 64
EPS = 1e-6
W_A = D_MODEL // 4
CONV_A_K = 31
H_B = 4
HGRN_HD = 64
W_B = H_B * HGRN_HD
CHUNK = 32
W_C = D_MODEL // 4
CONV_C_K = 3
W_D = D_MODEL // 4
POOL_WINDOWS = (2, 4, 8, 16)
POOL_GROUPS = 4
POOL_GC = W_D // POOL_GROUPS
POOL_OUT = D_MODEL // POOL_GROUPS
N_BRANCH = 4
D_FF = ((8 * D_MODEL + 3 * 256 - 1) // (3 * 256)) * 256
IN_WIDTHS = (W_A, W_A, W_B, W_B, W_B, W_B, W_B, W_C, W_C, W_C, W_D, N_BRANCH * D_MODEL)
N_IN = sum(IN_WIDTHS)

kernel_name = "hybrid_conv_hgrn2_pool_diffusion_step"


def rmsnorm(x, g):
    xf = x.astype(jnp.float32)
    y = xf * lax.rsqrt(jnp.mean(xf * xf, axis=-1, keepdims=True) + EPS)
    return y.astype(x.dtype) * g


def layernorm(x, g, b):
    xf = x.astype(jnp.float32)
    mu = jnp.mean(xf, axis=-1, keepdims=True)
    var = jnp.mean(jnp.square(xf - mu), axis=-1, keepdims=True)
    return ((xf - mu) * lax.rsqrt(var + EPS)).astype(x.dtype) * g + b


def along_grid(fn, u, rows, vertical):
    if rows is None:
        return fn(u)
    B, L, C = u.shape
    g = u.reshape(B, rows, GRID_W, C)
    if vertical:
        g = g.transpose(0, 2, 1, 3).reshape(B * GRID_W, rows, C)
        g = fn(g).reshape(B, GRID_W, rows, C).transpose(0, 2, 1, 3)
    else:
        g = fn(g.reshape(B * rows, GRID_W, C)).reshape(B, rows, GRID_W, C)
    return g.reshape(B, L, C)


def depthwise_conv(u, w):
    K, C = w.shape
    return lax.conv_general_dilated(
        u, w.astype(u.dtype)[:, None, :], window_strides=(1,),
        padding=[(K // 2, K // 2)], dimension_numbers=("NWC", "WIO", "NWC"),
        feature_group_count=C)


def multiscale_pool(u):
    N, L, C = u.shape
    uf = u.astype(jnp.float32)
    cs = jnp.concatenate([jnp.zeros((N, 1, C), jnp.float32), jnp.cumsum(uf, axis=1)], axis=1)
    t = jnp.arange(L)
    outs = []
    for gi, w in enumerate(POOL_WINDOWS):
        lo = jnp.clip(t - w // 2, 0, L)
        hi = jnp.clip(t + w - w // 2, 0, L)
        csg = cs[..., gi * POOL_GC:(gi + 1) * POOL_GC]
        cnt = (hi - lo).astype(jnp.float32)[None, :, None]
        mean = (csg[:, hi] - csg[:, lo]) / cnt
        outs.append(mean - uf[..., gi * POOL_GC:(gi + 1) * POOL_GC])
    return jnp.concatenate(outs, axis=-1).astype(u.dtype)


def log_forget(z, lb):
    zf = z.astype(jnp.float32)
    return jnp.logaddexp(jnp.log(lb), jnp.log1p(-lb) + jax.nn.log_sigmoid(zf))


def hgrn_chunk_scan(q, logf, v, s0):
    B, L, H, Dk = q.shape
    n = L // CHUNK

    def chunks(a):
        return a.astype(jnp.float32).reshape(B, n, CHUNK, H, a.shape[-1]).transpose(0, 3, 1, 2, 4)

    qc, lf, vc = chunks(q), chunks(logf), chunks(v)
    kc = -jnp.expm1(lf)
    bcum = jnp.cumsum(lf, axis=3)
    blast = bcum[..., -1:, :]
    mask = jnp.tril(jnp.ones((CHUNK, CHUNK), dtype=bool))
    diff = bcum[..., :, None, :] - bcum[..., None, :, :]
    decay = jnp.exp(jnp.where(mask[:, :, None], diff, -jnp.inf))
    scores = jnp.einsum("bhntk,bhntsk,bhnsk->bhnts", qc, decay, kc)
    o_intra = jnp.einsum("bhnts,bhnsv->bhntv", scores, vc)
    chunk_kv = jnp.einsum("bhnsk,bhnsv->bhnkv", kc * jnp.exp(blast - bcum), vc)
    chunk_decay = jnp.exp(blast[..., 0, :])

    def step(S, xs):
        dec, kv = xs
        return dec[..., None] * S + kv, S

    s_final, s_starts = lax.scan(
        step, s0.astype(jnp.float32),
        (chunk_decay.transpose(2, 0, 1, 3), chunk_kv.transpose(2, 0, 1, 3, 4)))
    o_inter = jnp.einsum("bhntk,nbhkv->bhntv", qc * jnp.exp(bcum), s_starts)
    o = (o_intra + o_inter).transpose(0, 2, 3, 1, 4).reshape(B, L, H, v.shape[-1])
    return o, s_final


def hgrn2_branch(q, f_fw, f_bw, i_in, g_out, s0, lb, norm_g, w_out):
    B, L, _ = q.shape
    heads = lambda t: t.reshape(B, L, H_B, HGRN_HD)
    flip = lambda t: jnp.flip(t, axis=1)
    qh, vh = heads(q), heads(i_in)
    lf_fw, lf_bw = heads(log_forget(f_fw, lb[0])), heads(log_forget(f_bw, lb[1]))
    o_fw, s_fw = hgrn_chunk_scan(qh, lf_fw, vh, s0[:, 0])
    o_bw, s_bw = hgrn_chunk_scan(flip(qh), flip(lf_bw), flip(vh), s0[:, 1])
    o = o_fw + flip(o_bw)
    o = o * lax.rsqrt(jnp.mean(o * o, axis=-1, keepdims=True) + EPS)
    o = o.reshape(B, L, W_B).astype(q.dtype) * norm_g * jax.nn.silu(g_out)
    return o @ w_out, jnp.stack([s_fw, s_bw], axis=1)


def token_mixers(h, s0, rows, lb, p):
    B, L, _ = h.shape
    offsets = np.cumsum(IN_WIDTHS)[:-1].tolist()
    z = h @ p["w_in"]
    a_val, a_gate, q, f_fw, f_bw, i_in, g_out, c_b, c_c, c_x, d_in, merge = jnp.split(z, offsets, axis=-1)
    u = a_val * jax.nn.sigmoid(a_gate)
    u = along_grid(lambda t: depthwise_conv(t, p["conv_a_w"]), u, rows, vertical=False) + p["conv_a_b"]
    y_a = jax.nn.silu(layernorm(u, p["ln_a_g"], p["ln_a_b"])) @ p["w_out_a"]
    y_b, s_final = hgrn2_branch(q, f_fw, f_bw, i_in, g_out, s0, lb, p["hgrn_norm_g"], p["w_out_b"])
    u = along_grid(lambda t: depthwise_conv(t, p["conv_c_w"]), c_c * c_x, rows, vertical=True)
    y_c = (c_b * u) @ p["w_out_c"]
    u = along_grid(multiscale_pool, d_in, rows, vertical=True)
    y_d = jnp.einsum("blgc,gcd->blgd", u.reshape(B, L, POOL_GROUPS, POOL_GC), p["pool_w"])
    y_d = y_d.reshape(B, L, D_MODEL) * p["pool_scale"]
    gates = jax.nn.sigmoid(merge).reshape(B, L, N_BRANCH, D_MODEL)
    merged = gates[..., 0, :] * y_a + gates[..., 1, :] * y_b + gates[..., 2, :] * y_c + gates[..., 3, :] * y_d
    return merged @ p["w_o"], s_final


def swiglu(h, w13, w2):
    gu = h @ w13
    gate, up = jnp.split(gu, 2, axis=-1)
    return (jax.nn.silu(gate) * up) @ w2


def trunk_layer(x, mod, s0, rows, lb, p):
    sh_m, sc_m, g_m, sh_f, sc_f, g_f = jnp.split(mod, 6, axis=-1)
    h = rmsnorm(x, p["norm_mix_g"]) * (1 + sc_m) + sh_m
    mix, s_final = token_mixers(h, s0, rows, lb, p)
    x = x + g_m * mix
    h = rmsnorm(x, p["norm_ffn_g"]) * (1 + sc_f) + sh_f
    x = x + g_f * swiglu(h, p["ffn_w13"], p["ffn_w2"])
    return x, s_final


def setup_inputs(seed: int = 0) -> dict:
    key = jax.random.key(seed)
    ks = jax.random.split(key, 32)

    def nrm(k, shape, scale):
        return jax.random.normal(k, shape, jnp.float32) * scale

    D = D_MODEL
    return {
        "x_prompt": nrm(ks[0], (BATCH, SEQ, D), 1.0),
        "x_sample": nrm(ks[1], (DEC_BATCH, DEC_SEQ, D), 1.0),
        "state_hgrn": nrm(ks[2], (DEC_BATCH, DEPTH, 2, H_B, HGRN_HD, HGRN_HD), 0.5),
        "c": nrm(ks[3], (DEC_BATCH, D), 1.0),
        "c_ctx": nrm(ks[4], (D,), 1.0),
        "ada_w": nrm(ks[5], (DEPTH, D, 6 * D), 0.5 * D ** -0.5),
        "ada_b": nrm(ks[6], (DEPTH, 6 * D), 0.02),
        "norm_mix_g": 1.0 + nrm(ks[7], (DEPTH, D), 0.05),
        "w_in": nrm(ks[8], (DEPTH, D, N_IN), D ** -0.5),
        "conv_a_w": nrm(ks[9], (DEPTH, CONV_A_K, W_A), CONV_A_K ** -0.5),
        "conv_a_b": nrm(ks[10], (DEPTH, W_A), 0.02),
        "ln_a_g": 1.0 + nrm(ks[11], (DEPTH, W_A), 0.05),
        "ln_a_b": nrm(ks[12], (DEPTH, W_A), 0.02),
        "w_out_a": nrm(ks[13], (DEPTH, W_A, D), W_A ** -0.5),
        "hgrn_lb_logits": nrm(ks[14], (DEPTH, 2, W_B), 0.5),
        "hgrn_norm_g": 1.0 + nrm(ks[15], (DEPTH, W_B), 0.05),
        "w_out_b": nrm(ks[16], (DEPTH, W_B, D), W_B ** -0.5),
        "conv_c_w": nrm(ks[17], (DEPTH, CONV_C_K, W_C), CONV_C_K ** -0.5),
        "w_out_c": nrm(ks[18], (DEPTH, W_C, D), W_C ** -0.5),
        "pool_w": nrm(ks[19], (DEPTH, POOL_GROUPS, POOL_GC, POOL_OUT), POOL_GC ** -0.5),
        "pool_scale": 1.0 + nrm(ks[20], (DEPTH, D), 0.1),
        "w_o": nrm(ks[21], (DEPTH, D, D), D ** -0.5),
        "norm_ffn_g": 1.0 + nrm(ks[22], (DEPTH, D), 0.05),
        "ffn_w13": nrm(ks[23], (DEPTH, D, 2 * D_FF), D ** -0.5),
        "ffn_w2": nrm(ks[24], (DEPTH, D_FF, D), D_FF ** -0.5),
        "final_norm_g": 1.0 + nrm(ks[25], (D,), 0.05),
    }


def reference(x_prompt, x_sample, state_hgrn, c, c_ctx, ada_w, ada_b, norm_mix_g, w_in,
              conv_a_w, conv_a_b, ln_a_g, ln_a_b, w_out_a, hgrn_lb_logits, hgrn_norm_g,
              w_out_b, conv_c_w, w_out_c, pool_w, pool_scale, w_o, norm_ffn_g,
              ffn_w13, ffn_w2, final_norm_g):
    rows = x_sample.shape[1] // GRID_W
    lb_all = jnp.cumsum(jax.nn.softmax(hgrn_lb_logits.astype(jnp.float32), axis=0), axis=0)
    lb_all = lb_all - lb_all[:1]

    y_p = x_prompt
    y_s = x_sample
    ctx_states = []
    for l in range(DEPTH):
        p = {
            "norm_mix_g": norm_mix_g[l], "w_in": w_in[l], "conv_a_w": conv_a_w[l],
            "conv_a_b": conv_a_b[l], "ln_a_g": ln_a_g[l], "ln_a_b": ln_a_b[l],
            "w_out_a": w_out_a[l], "hgrn_norm_g": hgrn_norm_g[l], "w_out_b": w_out_b[l],
            "conv_c_w": conv_c_w[l], "w_out_c": w_out_c[l], "pool_w": pool_w[l],
            "pool_scale": pool_scale[l], "w_o": w_o[l], "norm_ffn_g": norm_ffn_g[l],
            "ffn_w13": ffn_w13[l], "ffn_w2": ffn_w2[l],
        }
        mod_ctx = (jax.nn.silu(c_ctx) @ ada_w[l] + ada_b[l])[None, None, :]
        s0_ctx = jnp.zeros((y_p.shape[0], 2, H_B, HGRN_HD, HGRN_HD), jnp.float32)
        y_p, s_ctx = trunk_layer(y_p, mod_ctx, s0_ctx, None, lb_all[l], p)
        ctx_states.append(s_ctx.astype(x_prompt.dtype))
        mod_lat = (jax.nn.silu(c) @ ada_w[l] + ada_b[l])[:, None, :]
        y_s, _ = trunk_layer(y_s, mod_lat, state_hgrn[:, l], rows, lb_all[l], p)

    y_prompt = rmsnorm(y_p, final_norm_g)
    y_sample = rmsnorm(y_s, final_norm_g)
    new_state_hgrn = jnp.stack(ctx_states, axis=1)
    return (y_prompt, y_sample, new_state_hgrn)
```

```cpp
#ifndef EMU
#include <hip/hip_runtime.h>
#include <cstdio>
#include <cstdint>
#define LAS __attribute__((address_space(3)))
#define WAIT_V(n) asm volatile("s_waitcnt vmcnt(" #n ")" ::: "memory")
#define WAIT_L(n) asm volatile("s_waitcnt lgkmcnt(" #n ")" ::: "memory")
#define BAR_RAW() __builtin_amdgcn_s_barrier()
#define SCHED_BAR() __builtin_amdgcn_sched_barrier(0)
#define CFENCE() asm volatile("" ::: "memory")
#define SETPRIO(n) __builtin_amdgcn_s_setprio(n)
#define WAVE_SYNC() do { asm volatile("s_waitcnt lgkmcnt(0)" ::: "memory"); __builtin_amdgcn_wave_barrier(); asm volatile("" ::: "memory"); } while (0)
#define BLOCK_SYNC() __syncthreads()
#define GLDS16(gptr, ldsptr) __builtin_amdgcn_global_load_lds((const unsigned*)(gptr), (LAS unsigned*)(ldsptr), 16, 0, 0)
#define MFMA16(a, b, c) __builtin_amdgcn_mfma_f32_16x16x32_bf16(a, b, c, 0, 0, 0)
#define MFMA32(a, b, c) __builtin_amdgcn_mfma_f32_32x32x16_bf16(a, b, c, 0, 0, 0)
#define RFL(x) __builtin_amdgcn_readfirstlane(x)
#define SHFL_XOR(v, m, lane) __builtin_bit_cast(float, __builtin_amdgcn_ds_bpermute(((lane) ^ (m)) << 2, __builtin_bit_cast(int, (float)(v))))
#define FEXP(x) __expf(x)
#define FLOG(x) __logf(x)
#define FRSQ(x) rsqrtf(x)
#endif

#ifndef CFG_CB
#define CFG_CB 32
#define CFG_LB 4
#define CFG_LROWS 32
#endif
constexpr int D = 1024, DEPTH = 2, SEQ = 256, GW = 64;
constexpr int CB = CFG_CB, LBAT = CFG_LB, LROWS = CFG_LROWS, LSEQ = GW * LROWS;
constexpr int MC = CB * SEQ, ML = LBAT * LSEQ, M = MC + ML;
constexpr int NGRP = 1 + LBAT;
constexpr int NZ1 = 2816, NIN = 6912, DFF = 2816, NMOD = 6 * D;
constexpr int HT = 128;
constexpr float EPS = 1e-6f;
static_assert(MC % 256 == 0 && LSEQ % 256 == 0, "tiles must not straddle modulation groups");
constexpr int ZC_AV = 0, ZC_AG = 256, ZC_Q = 512, ZC_FF = 768, ZC_FB = 1024, ZC_I = 1280, ZC_GO = 1536, ZC_CB = 1792, ZC_CC = 2048, ZC_CX = 2304, ZC_D = 2560;

typedef unsigned short bf16_t;
typedef short bf16x8 __attribute__((ext_vector_type(8)));
typedef float f32x4 __attribute__((ext_vector_type(4)));
typedef float f32x16 __attribute__((ext_vector_type(16)));
typedef unsigned u32x4 __attribute__((ext_vector_type(4)));
typedef unsigned u32x2 __attribute__((ext_vector_type(2)));

__device__ __forceinline__ unsigned f2bf(float f) { unsigned u = __builtin_bit_cast(unsigned, f); return (u + 0x7fffu + ((u >> 16) & 1u)) >> 16; }
__device__ __forceinline__ unsigned pk2(float lo, float hi) { return f2bf(lo) | (f2bf(hi) << 16); }
__device__ __forceinline__ float bf2f(unsigned short b) { return __builtin_bit_cast(float, (unsigned)b << 16); }
__device__ __forceinline__ float bflo(unsigned w) { return __builtin_bit_cast(float, w << 16); }
__device__ __forceinline__ float bfhi(unsigned w) { return __builtin_bit_cast(float, w & 0xffff0000u); }
__device__ __forceinline__ float sigmoidf_(float x) { return 1.0f / (1.0f + FEXP(-x)); }
__device__ __forceinline__ float siluf_(float x) { return x / (1.0f + FEXP(-x)); }
__device__ __forceinline__ int crow(int r, int hi) { return (r & 3) + 8 * (r >> 2) + 4 * hi; }
__device__ __forceinline__ int grp_of_row(int r) { return r < MC ? 0 : 1 + (r - MC) / LSEQ; }

#ifdef EMU
__device__ __forceinline__ int tid_fresh() { return threadIdx.x; }
#else
__device__ __forceinline__ int tid_fresh() { int t = threadIdx.x; asm volatile("" : "+v"(t)); return t; }
#endif
namespace pg8 {
constexpr int BM = 256, BK = 64, HALF = 128, HTB = HALF * BK * 2  , STAGE_BYTES = 8 * HTB, NXCD = 8, WGM = 8;
__host__ __device__ __forceinline__ int lds_byte(int r, int c) { const int st = (r >> 4) * 2 + (c >> 5), rr = r & 15, cc = c & 31, ob = rr * 64 + cc * 2; return st * 1024 + (ob ^ (((ob >> 9) & 1) << 5)); }
__host__ __device__ __forceinline__ void stage_rc(int b, int& R, int& C) { const int st = b / 1024, sb = b % 1024, swz = sb ^ (((sb >> 9) & 1) << 5); R = (st >> 1) * 16 + swz / 64; C = (st & 1) * 32 + (swz % 64) / 2; }
__host__ __device__ __forceinline__ int perm32(int rho) { const int n = rho >> 4, i = rho & 15; return 8 * (i >> 2) + 4 * n + (i & 3); }

struct Unit { int pm, pn; };
struct Gemm { const bf16_t* A; const bf16_t* Bt; int M, N, K, apn_shift; size_t apn_bytes; };

struct StaticOrder {
    int nM, nN, nwg, G, c;
    __host__ __device__ void init(int M_, int N_, int G_, int c_) { nM = M_ / BM; nN = N_ / BM; nwg = nM * nN; G = G_; c = c_; }
    __host__ __device__ bool next(int i, Unit& u) const {
        const long L = (long)i * G + c; if (L >= nwg) return false;
        int wgid = (int)L; { const int q = nwg / NXCD, r = nwg % NXCD, xcd = wgid % NXCD, off = wgid / NXCD; wgid = (xcd < r ? xcd * (q + 1) : r * (q + 1) + (xcd - r) * q) + off; }
        const int nig = WGM * nN, gid = wgid / nig, fm = gid * WGM, gsz = (nM - fm) < WGM ? (nM - fm) : WGM;
        u.pm = fm + ((wgid % nig) % gsz); u.pn = (wgid % nig) / gsz; return true;
    }
};

struct EpiStoreBf16 {
    static constexpr bool PERM = true;
    bf16_t* O; int ldc;
    __device__ __forceinline__ void operator()(const f32x4 (&acc)[2][2][4][2], const Unit& u, int wr, int wc, int fr, int fq) const {
        const int row0 = u.pm * BM + wr * 64 + fr, col0 = u.pn * BM + wc * 32 + 8 * fq;
#pragma unroll
        for (int ai = 0; ai < 2; ++ai)
#pragma unroll
            for (int m = 0; m < 4; ++m) { bf16_t* rowp = O + (size_t)(row0 + ai * HALF + m * 16) * ldc + col0;
#pragma unroll
                for (int bj = 0; bj < 2; ++bj) { const f32x4 v0 = acc[ai][bj][m][0], v1 = acc[ai][bj][m][1];
                    u32x4 w; w.x = pk2(v0[0], v0[1]); w.y = pk2(v0[2], v0[3]); w.z = pk2(v1[0], v1[1]); w.w = pk2(v1[2], v1[3]);
                    *(u32x4*)(rowp + bj * HALF) = w; } }
    }
};
struct EpiSwiglu {
    static constexpr bool PERM = true;
    bf16_t* O; int ldc;
    __device__ __forceinline__ void operator()(const f32x4 (&acc)[2][2][4][2], const Unit& u, int wr, int wc, int fr, int fq) const {
        const int row0 = u.pm * BM + wr * 64 + fr, col0 = u.pn * HALF + wc * 32 + 8 * fq;
#pragma unroll
        for (int ai = 0; ai < 2; ++ai)
#pragma unroll
            for (int m = 0; m < 4; ++m) { bf16_t* rowp = O + (size_t)(row0 + ai * HALF + m * 16) * ldc + col0;
                float o[8];
#pragma unroll
                for (int n = 0; n < 2; ++n)
#pragma unroll
                    for (int j = 0; j < 4; ++j) { const float g = acc[ai][0][m][n][j], up = acc[ai][1][m][n][j]; o[n * 4 + j] = siluf_(g) * up; }
                u32x4 w; w.x = pk2(o[0], o[1]); w.y = pk2(o[2], o[3]); w.z = pk2(o[4], o[5]); w.w = pk2(o[6], o[7]);
                *(u32x4*)rowp = w; }
    }
};
struct EpiResid {
    static constexpr bool PERM = false;
    float* X; const float* gate;
    __device__ __forceinline__ void operator()(const f32x4 (&acc)[2][2][4][2], const Unit& u, int wr, int wc, int fr, int fq) const {
        const int row0 = u.pm * BM + wr * 64 + fr, col0 = u.pn * BM + wc * 32 + 4 * fq;
        const float* gp = gate + (size_t)grp_of_row(u.pm * BM) * NMOD + col0;
        f32x4 gv[2][2];
#pragma unroll
        for (int bj = 0; bj < 2; ++bj)
#pragma unroll
            for (int n = 0; n < 2; ++n) gv[bj][n] = *(const f32x4*)(gp + bj * HALF + n * 16);
#pragma unroll
        for (int ai = 0; ai < 2; ++ai)
#pragma unroll
            for (int m = 0; m < 4; ++m) { float* rowp = X + (size_t)(row0 + ai * HALF + m * 16) * D + col0;
#pragma unroll
                for (int bj = 0; bj < 2; ++bj)
#pragma unroll
                    for (int n = 0; n < 2; ++n) { f32x4* p = (f32x4*)(rowp + bj * HALF + n * 16); const f32x4 x = *p; *p = x + gv[bj][n] * acc[ai][bj][m][n]; } }
    }
};
struct EpiMerge {
    static constexpr bool PERM = false;
    const bf16_t* Y; bf16_t* O;
    __device__ __forceinline__ void operator()(const f32x4 (&acc)[2][2][4][2], const Unit& u, int wr, int wc, int fr, int fq) const {
        const int row0 = u.pm * BM + wr * 64 + fr, mc0 = u.pn * 64 + wc * 16 + 4 * fq;
#pragma unroll
        for (int ai = 0; ai < 2; ++ai)
#pragma unroll
            for (int m = 0; m < 4; ++m) { const int row = row0 + ai * HALF + m * 16; const bf16_t* yp = Y + (size_t)row * 4096 + mc0;
                u32x2 yv[4];
#pragma unroll
                for (int g = 0; g < 4; ++g) yv[g] = *(const u32x2*)(yp + g * 1024);
                float o[4] = {0.f, 0.f, 0.f, 0.f};
#pragma unroll
                for (int bj = 0; bj < 2; ++bj)
#pragma unroll
                    for (int n = 0; n < 2; ++n) { const f32x4 a = acc[ai][bj][m][n]; const u32x2 y = yv[2 * bj + n];
                        o[0] += sigmoidf_(a[0]) * bflo(y.x); o[1] += sigmoidf_(a[1]) * bfhi(y.x); o[2] += sigmoidf_(a[2]) * bflo(y.y); o[3] += sigmoidf_(a[3]) * bfhi(y.y); }
                u32x2 w; w.x = pk2(o[0], o[1]); w.y = pk2(o[2], o[3]);
                *(u32x2*)(O + (size_t)row * D + mc0) = w; }
    }
};

template <class Epi, class Sched, bool ALIGN_EPI = false, bool SP2 = false>
__device__ __forceinline__ void gemm_phase(LAS unsigned char* lds, const Gemm g, const Sched& S, const Epi& E) {
    const int tid = tid_fresh(), wid = RFL(tid >> 6), lane = tid & 63, wr = wid >> 2, wc = wid & 3, fr = lane & 15, fq = lane >> 4;
    const int K = g.K, nt = K / BK;
    unsigned voffA[2], voffB[2];
#pragma unroll
    for (int i = 0; i < 2; ++i) { int R, C; stage_rc(tid * 16 + i * 8192, R, C); const int Rb = Epi::PERM ? ((R & ~31) + perm32(R & 31)) : R;
        voffA[i] = (unsigned)(R * K + C) * 2u; voffB[i] = (unsigned)(Rb * K + C) * 2u; }
    const size_t kstep = (size_t)(BK * 2);
    const size_t hstep = (size_t)HALF * K * 2;
    const size_t tstep = 2 * hstep;
    const unsigned ldsw = (unsigned)wid * 1024u;
    const int aoff = lds_byte(wr * 64 + fr, fq * 8), boff = lds_byte(wc * 32 + fr, fq * 8);
#define PG8_SA(b, h) (((b) * 2 + (h)) * HTB)
#define PG8_SB(b, h) ((4 + (b) * 2 + (h)) * HTB)
#define PG8_STAGE(bufoff, gbase, voff) do { _Pragma("unroll") for (int _i = 0; _i < 2; ++_i) \
        GLDS16((const char*)(gbase) + (voff)[_i], lds + (bufoff) + ldsw + _i * 8192); } while (0)
#define PG8_LDA(dst, b, h) do { _Pragma("unroll") for (int m = 0; m < 4; ++m) _Pragma("unroll") for (int k = 0; k < 2; ++k) dst[m][k] = *(const LAS bf16x8*)(lds + PG8_SA(b, h) + aoff + m * 2048 + k * 1024); } while (0)
#define PG8_LDB(dst, b, h) do { _Pragma("unroll") for (int n = 0; n < 2; ++n) _Pragma("unroll") for (int k = 0; k < 2; ++k) dst[n][k] = *(const LAS bf16x8*)(lds + PG8_SB(b, h) + boff + n * 2048 + k * 1024); } while (0)
#define PG8_MMA(ai, bj, At, Bt) do { SETPRIO(1); _Pragma("unroll") for (int m = 0; m < 4; ++m) _Pragma("unroll") for (int n = 0; n < 2; ++n) _Pragma("unroll") for (int k = 0; k < 2; ++k) \
        acc[ai][bj][m][n] = MFMA16(Bt[n][k], At[m][k], acc[ai][bj][m][n]); SETPRIO(0); } while (0)
    Unit cur, nxt; int ui = 0;
    if (!S.next(0, cur)) return;
    f32x4 acc[2][2][4][2];
#pragma unroll
    for (int a = 0; a < 2; ++a)
#pragma unroll
        for (int b = 0; b < 2; ++b)
#pragma unroll
            for (int m = 0; m < 4; ++m)
#pragma unroll
                for (int n = 0; n < 2; ++n) acc[a][b][m][n] = (f32x4){0.f, 0.f, 0.f, 0.f};
    bf16x8 At[4][2], B0[2][2], B1[2][2];
    const char* cA = (const char*)g.A + (size_t)cur.pm * tstep + (size_t)(cur.pn >> g.apn_shift) * g.apn_bytes; const char* cB = (const char*)g.Bt + (size_t)cur.pn * tstep;
    if constexpr (SP2) {
        PG8_STAGE(PG8_SB(0, 0), cB, voffB); PG8_STAGE(PG8_SB(0, 1), cB + hstep, voffB); PG8_STAGE(PG8_SA(0, 0), cA, voffA); PG8_STAGE(PG8_SA(0, 1), cA + hstep, voffA);
        if (wr == 1) BAR_RAW();
        WAIT_V(2); BAR_RAW();
        PG8_STAGE(PG8_SB(1, 0), cB + kstep, voffB); PG8_STAGE(PG8_SA(1, 0), cA + kstep, voffA); PG8_STAGE(PG8_SB(1, 1), cB + hstep + kstep, voffB);
        WAIT_V(6); BAR_RAW();
    } else {
        PG8_STAGE(PG8_SB(0, 0), cB, voffB); PG8_STAGE(PG8_SA(0, 0), cA, voffA); PG8_STAGE(PG8_SB(0, 1), cB + hstep, voffB); PG8_STAGE(PG8_SA(0, 1), cA + hstep, voffA);
        if (wr == 1) BAR_RAW();
        WAIT_V(4); BAR_RAW();
        PG8_STAGE(PG8_SB(1, 0), cB + kstep, voffB); PG8_STAGE(PG8_SA(1, 0), cA + kstep, voffA); PG8_STAGE(PG8_SB(1, 1), cB + hstep + kstep, voffB);
        WAIT_V(6); BAR_RAW();
    }
    for (;;) {
        const bool has_next = S.next(ui + 1, nxt);
        const char* nA = has_next ? (const char*)g.A + (size_t)nxt.pm * tstep + (size_t)(nxt.pn >> g.apn_shift) * g.apn_bytes : cA; const char* nB = has_next ? (const char*)g.Bt + (size_t)nxt.pn * tstep : cB;
        for (int t = 0; t < nt; t += 2) {
            const bool last = (t == nt - 2);
            const char* a1 = cA + (size_t)(t + 1) * kstep;
            const char* a2 = last ? nA : cA + (size_t)(t + 2) * kstep; const char* b2 = last ? nB : cB + (size_t)(t + 2) * kstep;
            const char* a3 = a2 + kstep; const char* b3 = b2 + kstep;
            if constexpr (SP2) {
            PG8_LDB(B0, 0, 0); PG8_LDB(B1, 0, 1); SCHED_BAR(); PG8_LDA(At, 0, 0); PG8_STAGE(PG8_SA(1, 1), a1 + hstep, voffA);
            WAIT_V(8); WAIT_L(0); BAR_RAW(); PG8_MMA(0, 0, At, B0); PG8_MMA(0, 1, At, B1); BAR_RAW(); SCHED_BAR();
            PG8_LDA(At, 0, 1); PG8_STAGE(PG8_SB(0, 0), b2, voffB); PG8_STAGE(PG8_SB(0, 1), b2 + hstep, voffB); PG8_STAGE(PG8_SA(0, 0), a2, voffA);
            WAIT_V(8); WAIT_L(0); BAR_RAW(); PG8_MMA(1, 0, At, B0); PG8_MMA(1, 1, At, B1); BAR_RAW(); SCHED_BAR();
            PG8_LDB(B0, 1, 0); PG8_LDB(B1, 1, 1); SCHED_BAR(); PG8_LDA(At, 1, 0); PG8_STAGE(PG8_SA(0, 1), a2 + hstep, voffA);
            WAIT_V(8); WAIT_L(0); BAR_RAW(); PG8_MMA(0, 0, At, B0); PG8_MMA(0, 1, At, B1); BAR_RAW(); SCHED_BAR();
            PG8_LDA(At, 1, 1); PG8_STAGE(PG8_SB(1, 0), b3, voffB); PG8_STAGE(PG8_SB(1, 1), b3 + hstep, voffB); PG8_STAGE(PG8_SA(1, 0), a3, voffA);
            WAIT_V(8); WAIT_L(0); BAR_RAW(); PG8_MMA(1, 0, At, B0); PG8_MMA(1, 1, At, B1); BAR_RAW(); SCHED_BAR();
            } else {
            PG8_LDB(B0, 0, 0); SCHED_BAR(); PG8_LDA(At, 0, 0); PG8_STAGE(PG8_SA(1, 1), a1 + hstep, voffA);
            WAIT_L(8); BAR_RAW(); WAIT_L(0); PG8_MMA(0, 0, At, B0); BAR_RAW(); SCHED_BAR();
            PG8_LDB(B1, 0, 1); PG8_STAGE(PG8_SB(0, 0), b2, voffB);
            BAR_RAW(); WAIT_L(0); PG8_MMA(0, 1, At, B1); BAR_RAW();
            PG8_LDA(At, 0, 1); PG8_STAGE(PG8_SA(0, 0), a2, voffA);
            BAR_RAW(); WAIT_L(0); PG8_MMA(1, 0, At, B0); BAR_RAW(); SCHED_BAR();
            PG8_STAGE(PG8_SB(0, 1), b2 + hstep, voffB);
            WAIT_V(6); BAR_RAW(); PG8_MMA(1, 1, At, B1); BAR_RAW();
            PG8_LDB(B0, 1, 0); SCHED_BAR(); PG8_LDA(At, 1, 0); PG8_STAGE(PG8_SA(0, 1), a2 + hstep, voffA);
            WAIT_L(8); BAR_RAW(); WAIT_L(0); PG8_MMA(0, 0, At, B0); BAR_RAW(); SCHED_BAR();
            PG8_LDB(B1, 1, 1); PG8_STAGE(PG8_SB(1, 0), b3, voffB);
            BAR_RAW(); WAIT_L(0); PG8_MMA(0, 1, At, B1); BAR_RAW();
            PG8_LDA(At, 1, 1); PG8_STAGE(PG8_SA(1, 0), a3, voffA);
            BAR_RAW(); WAIT_L(0); PG8_MMA(1, 0, At, B0); BAR_RAW(); SCHED_BAR();
            PG8_STAGE(PG8_SB(1, 1), b3 + hstep, voffB);
            WAIT_V(6); BAR_RAW(); PG8_MMA(1, 1, At, B1); BAR_RAW();
            }
        }
        if constexpr (ALIGN_EPI) { if (wr == 0) BAR_RAW(); }
        E(acc, cur, wr, wc, fr, fq);
        if (!has_next) break;
#pragma unroll
        for (int a = 0; a < 2; ++a)
#pragma unroll
            for (int b = 0; b < 2; ++b)
#pragma unroll
                for (int m = 0; m < 4; ++m)
#pragma unroll
                    for (int n = 0; n < 2; ++n) acc[a][b][m][n] = (f32x4){0.f, 0.f, 0.f, 0.f};
        cur = nxt; cA = nA; cB = nB; ++ui;
        if constexpr (ALIGN_EPI) { if (wr == 1) BAR_RAW(); }
    }
    WAIT_V(0);
    if constexpr (!ALIGN_EPI) { if (wr == 0) BAR_RAW(); }
    BAR_RAW();
#undef PG8_SA
#undef PG8_SB
#undef PG8_STAGE
#undef PG8_LDA
#undef PG8_LDB
#undef PG8_MMA
}
}

constexpr int NWAVES = 8, NTHR = NWAVES * 64;
constexpr size_t MiB = 1u << 20;
constexpr size_t WS_CTL = 0, CTL_ZERO_BYTES = 64 * 1024;
constexpr size_t WS_MOD = 1 * MiB;
constexpr size_t WS_WB = 2 * MiB;
constexpr size_t WB_WIN1 = 0, WB_WG = WB_WIN1 + (size_t)NZ1 * D * 2, WB_WOUT = WB_WG + (size_t)4096 * D * 2, WB_WO = WB_WOUT + (size_t)4096 * 256 * 2,
                 WB_W13 = WB_WO + (size_t)D * D * 2, WB_W2 = WB_W13 + (size_t)2 * DFF * D * 2, WB_END = WB_W2 + (size_t)D * DFF * 2;
static_assert(WB_END == 34 * MiB, "weight block");
constexpr size_t WS_HB = 36 * MiB;
constexpr size_t WS_U = 68 * MiB;
constexpr size_t WS_BIG = 100 * MiB;
constexpr size_t WS_OLOC = 188 * MiB;
constexpr size_t WS_QS = 220 * MiB;
constexpr size_t WS_KVT = 236 * MiB;
constexpr size_t WS_DECT = 252 * MiB;
constexpr size_t WS_END = 253 * MiB;
static_assert((size_t)M * 4096 * 2 <= 128 * MiB && (size_t)M * NZ1 * 2 <= 88 * MiB && (size_t)2 * M * 256 * 4 <= 32 * MiB, "ws map");
constexpr int CW_BAR = 1024;
constexpr int RING_BYTES = 131072, MISC_OFF = RING_BYTES + 320, LDS_BYTES = 147456;

constexpr int PH_PRO = 0, PH_PER_LAYER = 11, PH_FINAL = 1 + PH_PER_LAYER * DEPTH, N_PHASES = PH_FINAL + 1;
enum { LP_CONV = 0, LP_NORMA, LP_Z1, LP_MIX, LP_H2, LP_Y, LP_MERGE, LP_WO, LP_NORMF, LP_W13, LP_W2 };
enum { I_XP = 0, I_XS, I_STATE, I_C, I_CCTX, I_ADAW, I_ADAB, I_NMG, I_WIN, I_CAW, I_CAB, I_LNG, I_LNB, I_WOA, I_LBL, I_HNG, I_WOB, I_CCW, I_WOC, I_PW, I_PS, I_WO, I_NFG, I_W13, I_W2, I_FNG };

struct Args { const float* in[26]; float* out; unsigned char* ws; int ph_lo, ph_hi; };
#ifdef EMU
typedef const Args* ArgsP;
#define LAUNDER(p) do { } while (0)
#define LAUNDER_V(v) do { } while (0)
#else
typedef const __attribute__((address_space(4))) Args* ArgsP;
#define LAUNDER(p) asm volatile("" : "+s"(p))
#define LAUNDER_V(v) asm volatile("" : "+v"(v))
#endif
struct Frame { LAS unsigned char* lds; ArgsP ap; int G, bid; };
#define PHASE_IDS() const int tid_ = tid_fresh(), lane_ = tid_ & 63, wave_ = RFL(tid_ >> 6); (void)tid_; (void)lane_; (void)wave_
#define INP(i) (F.ap->in[i])
#define WSB(off) (F.ap->ws + (off))
#define P_X() (F.ap->out)
#define P_NS() (F.ap->out + (size_t)M * D)
#define P_MOD() ((float*)WSB(WS_MOD))
#define P_HB() ((bf16_t*)WSB(WS_HB))
#define P_U(i) ((bf16_t*)WSB(WS_U) + (size_t)(i) * M * 256)
#define P_Z1() ((bf16_t*)WSB(WS_BIG))
#define P_OLOC() ((float*)WSB(WS_OLOC))
#define P_QS() ((bf16_t*)WSB(WS_QS))
#define P_KVT() ((float*)WSB(WS_KVT))
#define P_DECT() ((float*)WSB(WS_DECT))

#ifndef EMU
#define XB_TMO      128
#define XB_XCNT(j)  (256  + 64 * (j))
#define XB_XSUB(j)  (1280 + 64 * (j))
#define XB_XGEN(j)  (2304 + 64 * (j))
#define XB_TOP      3328
#define XB_TOPGEN   3392
#define XCD_BAR_WORDS 3456
#define XB_SPIN_CAP (1u << 18)
__device__ __forceinline__ unsigned xb_ld(unsigned* p)              { return __hip_atomic_load(p, __ATOMIC_RELAXED, __HIP_MEMORY_SCOPE_AGENT); }
__device__ __forceinline__ unsigned xb_add(unsigned* p, unsigned v) { return __hip_atomic_fetch_add(p, v, __ATOMIC_RELAXED, __HIP_MEMORY_SCOPE_AGENT); }
__device__ __forceinline__ unsigned xb_xcc_id() { return (unsigned)__builtin_amdgcn_s_getreg((3 << 11) | 20) & 0xFu; }
#define XB_SPIN(cond, bar) do { unsigned _sp = 0; while (cond) { __builtin_amdgcn_s_sleep(1); \
    if ((++_sp & 255u) == 0u) { if (xb_ld(&(bar)[XB_TMO])) break; if (_sp > XB_SPIN_CAP) { atomicAdd(&(bar)[XB_TMO], 1u); break; } } } } while (0)
__device__ __forceinline__ void xcd_barrier_complete(unsigned* bar, unsigned x, unsigned& nloc, unsigned& nx) {
    const unsigned G = gridDim.x * gridDim.y * gridDim.z;
    unsigned sum, cnt, mine, sp = 0u;
    for (;;) {
        sum = 0u; cnt = 0u; mine = 0u;
#pragma unroll
        for (unsigned j = 0; j < 16; ++j) { const unsigned c = xb_ld(&bar[XB_XCNT(j)]); sum += c; cnt += (c > 0u) ? 1u : 0u; mine = (j == x) ? c : mine; }
        if (sum == G) break;
        __builtin_amdgcn_s_sleep(1);
        if ((++sp & 255u) == 0u) { if (xb_ld(&bar[XB_TMO])) break; if (sp > XB_SPIN_CAP) { atomicAdd(&bar[XB_TMO], 1u); break; } }
    }
    nloc = mine > 0u ? mine : 1u; nx = cnt > 0u ? cnt : 1u;
}
__device__ __forceinline__ void xcd_barrier(unsigned* bar, volatile LAS unsigned* st) {
    asm volatile("s_waitcnt vmcnt(0)" ::: "memory");
    __syncthreads();
    if (threadIdx.x == 0) {
        __builtin_amdgcn_s_waitcnt(0);
        const unsigned x = xb_xcc_id();
        unsigned nloc = st[0], nx = st[1];
        if (nloc == 0u) { xcd_barrier_complete(bar, x, nloc, nx); st[0] = nloc; st[1] = nx; }
        const unsigned old = xb_add(&bar[XB_XSUB(x)], 1u);
        const unsigned gen = old / nloc;
        if (old + 1u == (gen + 1u) * nloc) {
            __builtin_amdgcn_fence(__ATOMIC_RELEASE, "agent");
            asm volatile("s_waitcnt vmcnt(0)" ::: "memory");
            const unsigned og = xb_add(&bar[XB_TOP], 1u);
            const unsigned tg = og / nx;
            if (og + 1u == (tg + 1u) * nx) xb_add(&bar[XB_TOPGEN], 1u);
            else XB_SPIN(xb_ld(&bar[XB_TOPGEN]) == tg, bar);
            __builtin_amdgcn_fence(__ATOMIC_ACQUIRE, "agent");
            xb_add(&bar[XB_XGEN(x)], 1u);
            asm volatile("s_waitcnt vmcnt(0)" ::: "memory");
        } else {
            XB_SPIN(xb_ld(&bar[XB_XGEN(x)]) == gen, bar);
            __builtin_amdgcn_fence(__ATOMIC_ACQUIRE, "agent");
            asm volatile("s_waitcnt vmcnt(0)" ::: "memory");
        }
    }
    __syncthreads();
}
#endif

__device__ __forceinline__ float wave_sum(float v, int lane) {
#pragma unroll
    for (int o = 1; o < 64; o <<= 1) v += SHFL_XOR(v, o, lane);
    return v;
}

template <class V>
__device__ __forceinline__ void transpose_item(const V& val, int K, bf16_t* WT, LAS float* scr, int item, int nblk, int lane) {
    const int kb = item / nblk, nb = item % nblk, k0 = 64 * kb, n0 = 32 * nb;
#pragma unroll 8
    for (int i = 0; i < 32; ++i) { const int kk = 2 * i + (lane >> 5); scr[kk * 33 + (lane & 31)] = val(k0 + kk, n0 + (lane & 31)); }
    WAVE_SYNC();
    const int c = lane & 7;
#pragma unroll
    for (int j = 0; j < 4; ++j) { const int n = (lane >> 3) + 8 * j; const LAS float* s = scr + (8 * c) * 33 + n;
        u32x4 o; o.x = pk2(s[0 * 33], s[1 * 33]); o.y = pk2(s[2 * 33], s[3 * 33]); o.z = pk2(s[4 * 33], s[5 * 33]); o.w = pk2(s[6 * 33], s[7 * 33]);
        *(u32x4*)(WT + (size_t)(n0 + n) * K + k0 + 8 * c) = o; }
    WAVE_SYNC();
}
struct ValWin1 { const float* w; __device__ __forceinline__ float operator()(int k, int n) const { return w[(size_t)k * NIN + n]; } };
struct ValWg { const float* w; __device__ __forceinline__ float operator()(int k, int n) const {
    const int pn = n >> 8, ct = n & 255, gi = 2 * (ct >> 7) + ((ct >> 4) & 1), cm = 16 * ((ct >> 5) & 3) + (ct & 15);
    return w[(size_t)k * NIN + NZ1 + gi * 1024 + 64 * pn + cm]; } };
struct ValWout { const float *wa, *wb, *wc, *pw, *ps; __device__ __forceinline__ float operator()(int k, int n) const {
    const int br = n >> 10, c = n & 1023;
    if (br == 0) return wa[(size_t)k * D + c];
    if (br == 1) return wb[(size_t)k * D + c];
    if (br == 2) return wc[(size_t)k * D + c];
    return ((k >> 6) == (c >> 8)) ? pw[((size_t)(c >> 8) * 64 + (k & 63)) * 256 + (c & 255)] * ps[c] : 0.f; } };
struct ValPlain { const float* w; int ld; __device__ __forceinline__ float operator()(int k, int n) const { return w[(size_t)k * ld + n]; } };
struct ValW13 { const float* w; __device__ __forceinline__ float operator()(int k, int n) const {
    const int pn = n >> 8, ct = n & 255; const int col = (ct < 128) ? 128 * pn + ct : DFF + 128 * pn + (ct - 128);
    return w[(size_t)k * (2 * DFF) + col]; } };

__device__ __forceinline__ void p_convert(Frame& F, int l) {
    LAUNDER(F.ap); PHASE_IDS();
    LAS float* scr = (LAS float*)(F.lds + wave_ * 8704);
    const int gw = F.bid * NWAVES + wave_, NGW = F.G * NWAVES;
    constexpr int I1 = (D / 64) * (NZ1 / 32), I2 = (D / 64) * (4096 / 32), I3 = (256 / 64) * (4096 / 32), I4 = (D / 64) * (D / 32), I5 = (D / 64) * (2 * DFF / 32), I6 = (DFF / 64) * (D / 32);
    unsigned char* wb = WSB(WS_WB);
    for (int it = gw; it < I1 + I2 + I3 + I4 + I5 + I6; it += NGW) {
        int r = it;
        if (r < I1) { const ValWin1 v{INP(I_WIN) + (size_t)l * D * NIN}; transpose_item(v, D, (bf16_t*)(wb + WB_WIN1), scr, r, NZ1 / 32, lane_); continue; } r -= I1;
        if (r < I2) { const ValWg v{INP(I_WIN) + (size_t)l * D * NIN}; transpose_item(v, D, (bf16_t*)(wb + WB_WG), scr, r, 4096 / 32, lane_); continue; } r -= I2;
        if (r < I3) { const ValWout v{INP(I_WOA) + (size_t)l * 256 * D, INP(I_WOB) + (size_t)l * 256 * D, INP(I_WOC) + (size_t)l * 256 * D, INP(I_PW) + (size_t)l * 4 * 64 * 256, INP(I_PS) + (size_t)l * D};
            transpose_item(v, 256, (bf16_t*)(wb + WB_WOUT), scr, r, 4096 / 32, lane_); continue; } r -= I3;
        if (r < I4) { const ValPlain v{INP(I_WO) + (size_t)l * D * D, D}; transpose_item(v, D, (bf16_t*)(wb + WB_WO), scr, r, D / 32, lane_); continue; } r -= I4;
        if (r < I5) { const ValW13 v{INP(I_W13) + (size_t)l * D * 2 * DFF}; transpose_item(v, D, (bf16_t*)(wb + WB_W13), scr, r, 2 * DFF / 32, lane_); continue; } r -= I5;
        { const ValPlain v{INP(I_W2) + (size_t)l * DFF * D, D}; transpose_item(v, DFF, (bf16_t*)(wb + WB_W2), scr, r, D / 32, lane_); }
    }
}

__device__ __forceinline__ void p_mod(Frame& F) {
    LAUNDER(F.ap); PHASE_IDS();
    LAS float* sil = (LAS float*)F.lds;
    LAS float* red = (LAS float*)(F.lds + NGRP * 4096);
    const int nitems = DEPTH * (NMOD / 256);
    if (F.bid >= nitems) return;
    for (int i = tid_; i < NGRP * D; i += NTHR) { const int g = i / D, k = i % D; const float c = (g == 0) ? INP(I_CCTX)[k] : INP(I_C)[(size_t)(g - 1) * D + k]; sil[i] = siluf_(c); }
    BLOCK_SYNC();
    for (int it = F.bid; it < nitems; it += F.G) {
        const int l = it / (NMOD / 256), n0 = (it % (NMOD / 256)) * 256 + 4 * lane_;
        const float* w = INP(I_ADAW) + (size_t)l * D * NMOD + n0;
        f32x4 acc[NGRP];
#pragma unroll
        for (int g = 0; g < NGRP; ++g) acc[g] = (f32x4){0.f, 0.f, 0.f, 0.f};
        for (int k = 128 * wave_; k < 128 * wave_ + 128; ++k) { const f32x4 a = *(const f32x4*)(w + (size_t)k * NMOD);
#pragma unroll
            for (int g = 0; g < NGRP; ++g) acc[g] += a * sil[g * D + k]; }
#pragma unroll
        for (int g = 0; g < NGRP; ++g) *(LAS f32x4*)(red + (wave_ * NGRP + g) * 256 + 4 * lane_) = acc[g];
        BLOCK_SYNC();
        for (int i = tid_; i < NGRP * 256; i += NTHR) { const int g = i / 256, c = i % 256; float s = 0.f;
#pragma unroll
            for (int w8 = 0; w8 < 8; ++w8) s += red[(w8 * NGRP + g) * 256 + c];
            const int n = (it % (NMOD / 256)) * 256 + c;
            P_MOD()[((size_t)l * NGRP + g) * NMOD + n] = s + INP(I_ADAB)[(size_t)l * NMOD + n]; }
        BLOCK_SYNC();
    }
}

__device__ __forceinline__ void p_norm(Frame& F, int l, bool ffn, bool first) {
    LAUNDER(F.ap); PHASE_IDS();
    const int gw = F.bid * NWAVES + wave_, NGW = F.G * NWAVES;
    const float* gvec = INP(ffn ? I_NFG : I_NMG) + (size_t)l * D;
    float* X = P_X(); bf16_t* HB = P_HB(); const float* xp = INP(I_XP); const float* xs = INP(I_XS);
    const float* modl = P_MOD() + (size_t)l * NGRP * NMOD + (ffn ? 3 * D : 0);
    for (int m = gw; m < M; m += NGW) {
        const float* src = first ? (m < MC ? xp + (size_t)m * D : xs + (size_t)(m - MC) * D) : X + (size_t)m * D;
        const float* md = modl + (size_t)grp_of_row(m) * NMOD;
        f32x4 v[4]; float s = 0.f;
#pragma unroll
        for (int j = 0; j < 4; ++j) { v[j] = *(const f32x4*)(src + 4 * lane_ + 256 * j); s += (v[j][0] * v[j][0] + v[j][1] * v[j][1]) + (v[j][2] * v[j][2] + v[j][3] * v[j][3]); }
        const float r = FRSQ(wave_sum(s, lane_) * (1.f / D) + EPS);
#pragma unroll
        for (int j = 0; j < 4; ++j) { const int c = 4 * lane_ + 256 * j;
            if (first) *(f32x4*)(X + (size_t)m * D + c) = v[j];
            const f32x4 g = *(const f32x4*)(gvec + c), sh = *(const f32x4*)(md + c), sc = *(const f32x4*)(md + D + c);
            const f32x4 h = v[j] * r * g * (sc + 1.f) + sh;
            u32x2 w; w.x = pk2(h[0], h[1]); w.y = pk2(h[2], h[3]);
            *(u32x2*)(HB + (size_t)m * D + c) = w; }
    }
}
__device__ __forceinline__ void p_final(Frame& F) {
    LAUNDER(F.ap); PHASE_IDS();
    const int gw = F.bid * NWAVES + wave_, NGW = F.G * NWAVES;
    float* X = P_X(); const float* fg = INP(I_FNG);
    for (int m = gw; m < M; m += NGW) {
        float* src = X + (size_t)m * D; f32x4 v[4]; float s = 0.f;
#pragma unroll
        for (int j = 0; j < 4; ++j) { v[j] = *(const f32x4*)(src + 4 * lane_ + 256 * j); s += (v[j][0] * v[j][0] + v[j][1] * v[j][1]) + (v[j][2] * v[j][2] + v[j][3] * v[j][3]); }
        const float r = FRSQ(wave_sum(s, lane_) * (1.f / D) + EPS);
#pragma unroll
        for (int j = 0; j < 4; ++j) { const int c = 4 * lane_ + 256 * j; const f32x4 g = *(const f32x4*)(fg + c); *(f32x4*)(src + c) = v[j] * r * g; }
    }
}

__device__ __forceinline__ void p_mixA(Frame& F, int l) {
    LAUNDER(F.ap); PHASE_IDS();
    LAS float* gl = (LAS float*)F.lds;
    const float* cw = INP(I_CAW) + (size_t)l * 31 * 256; const float* cb = INP(I_CAB) + (size_t)l * 256;
    const float* lg = INP(I_LNG) + (size_t)l * 256; const float* lb = INP(I_LNB) + (size_t)l * 256;
    const bf16_t* Z1 = P_Z1(); bf16_t* UA = P_U(0);
    for (int it = F.bid; it < M / 64; it += F.G) {
        const int t0 = it * 64; int seg0, seg1;
        if (t0 < MC) { seg0 = (t0 / SEQ) * SEQ; seg1 = seg0 + SEQ; } else { seg0 = t0; seg1 = t0 + 64; }
        for (int i = tid_; i < 94 * 32; i += NTHR) { const int r = i >> 5, c8 = (i & 31) * 8, t = t0 - 15 + r;
            float o[8];
            if (t >= seg0 && t < seg1) { const bf16_t* zp = Z1 + (size_t)t * NZ1; const u32x4 a = *(const u32x4*)(zp + ZC_AV + c8), g = *(const u32x4*)(zp + ZC_AG + c8);
                o[0] = bflo(a.x) * sigmoidf_(bflo(g.x)); o[1] = bfhi(a.x) * sigmoidf_(bfhi(g.x)); o[2] = bflo(a.y) * sigmoidf_(bflo(g.y)); o[3] = bfhi(a.y) * sigmoidf_(bfhi(g.y));
                o[4] = bflo(a.z) * sigmoidf_(bflo(g.z)); o[5] = bfhi(a.z) * sigmoidf_(bfhi(g.z)); o[6] = bflo(a.w) * sigmoidf_(bflo(g.w)); o[7] = bfhi(a.w) * sigmoidf_(bfhi(g.w)); }
            else {
#pragma unroll
                for (int j = 0; j < 8; ++j) o[j] = 0.f; }
            *(LAS f32x4*)(gl + r * 256 + c8) = (f32x4){o[0], o[1], o[2], o[3]}; *(LAS f32x4*)(gl + r * 256 + c8 + 4) = (f32x4){o[4], o[5], o[6], o[7]}; }
        BLOCK_SYNC();
        const int c = tid_ & 255, half = tid_ >> 8;
        float w[31], acc[32];
#pragma unroll
        for (int k = 0; k < 31; ++k) w[k] = cw[k * 256 + c];
        const float bias = cb[c];
#pragma unroll
        for (int o = 0; o < 32; ++o) acc[o] = bias;
#pragma unroll
        for (int i = 0; i < 62; ++i) { const float v = gl[(32 * half + i) * 256 + c];
#pragma unroll
            for (int o = 0; o < 32; ++o) { const int k = i - o; if (k >= 0 && k <= 30) acc[o] += w[k] * v; } }
        BLOCK_SYNC();
#pragma unroll
        for (int o = 0; o < 32; ++o) gl[(32 * half + o) * 256 + c] = acc[o];
        BLOCK_SYNC();
        for (int tt = 0; tt < 8; ++tt) { const int tl = wave_ * 8 + tt; const f32x4 v = *(const LAS f32x4*)(gl + tl * 256 + 4 * lane_);
            const float mu = wave_sum((v[0] + v[1]) + (v[2] + v[3]), lane_) * (1.f / 256.f); const f32x4 dlt = v - mu;
            const float var = wave_sum((dlt[0] * dlt[0] + dlt[1] * dlt[1]) + (dlt[2] * dlt[2] + dlt[3] * dlt[3]), lane_) * (1.f / 256.f);
            const float rs = FRSQ(var + EPS); const f32x4 g = *(const f32x4*)(lg + 4 * lane_), b = *(const f32x4*)(lb + 4 * lane_);
            const f32x4 y = dlt * rs * g + b;
            u32x2 o; o.x = pk2(siluf_(y[0]), siluf_(y[1])); o.y = pk2(siluf_(y[2]), siluf_(y[3]));
            *(u32x2*)(UA + (size_t)(t0 + tl) * 256 + 4 * lane_) = o; }
        BLOCK_SYNC();
    }
}

__device__ __forceinline__ void p_mixCD(Frame& F, int l, int wslot, int nslots) {
    LAUNDER(F.ap); PHASE_IDS();
    const float* ccw = INP(I_CCW) + (size_t)l * 3 * 256; const int c4 = 4 * lane_;
    const f32x4 w0 = *(const f32x4*)(ccw + c4), w1 = *(const f32x4*)(ccw + 256 + c4), w2 = *(const f32x4*)(ccw + 512 + c4);
    const int pg = lane_ >> 4, win = 2 << pg;
    const bf16_t* Z1 = P_Z1(); bf16_t* UC = P_U(2); bf16_t* UD = P_U(3);
    for (int t = wslot; t < M; t += nslots) {
        int pos, L, stride;
        if (t < MC) { pos = t % SEQ; L = SEQ; stride = 1; } else { pos = ((t - MC) % LSEQ) / GW; L = LROWS; stride = GW; }
        const bf16_t* zp = Z1 + (size_t)t * NZ1;
        f32x4 u = (f32x4){0.f, 0.f, 0.f, 0.f};
#pragma unroll
        for (int j = -1; j <= 1; ++j) { const int p = pos + j; if (p >= 0 && p < L) { const bf16_t* q = zp + (ptrdiff_t)j * stride * NZ1; const u32x2 cc = *(const u32x2*)(q + ZC_CC + c4), cx = *(const u32x2*)(q + ZC_CX + c4);
            const f32x4 pr = (f32x4){bflo(cc.x) * bflo(cx.x), bfhi(cc.x) * bfhi(cx.x), bflo(cc.y) * bflo(cx.y), bfhi(cc.y) * bfhi(cx.y)};
            u += pr * (j < 0 ? w0 : (j == 0 ? w1 : w2)); } }
        { const u32x2 cbv = *(const u32x2*)(zp + ZC_CB + c4); u32x2 o; o.x = pk2(bflo(cbv.x) * u[0], bfhi(cbv.x) * u[1]); o.y = pk2(bflo(cbv.y) * u[2], bfhi(cbv.y) * u[3]);
          *(u32x2*)(UC + (size_t)t * 256 + c4) = o; }
        f32x4 s = (f32x4){0.f, 0.f, 0.f, 0.f}; int cnt = 0; f32x4 self = s;
        for (int j = -8; j < 8; ++j) { const int p = pos + j; const bool in = (j >= -(win >> 1)) && (j < (win >> 1)) && p >= 0 && p < L;
            if (in) { const u32x2 d = *(const u32x2*)(zp + (ptrdiff_t)j * stride * NZ1 + ZC_D + c4); const f32x4 dv = (f32x4){bflo(d.x), bfhi(d.x), bflo(d.y), bfhi(d.y)}; s += dv; ++cnt; if (j == 0) self = dv; } }
        { const float ic = 1.0f / (float)cnt; const f32x4 r = s * ic - self; u32x2 o; o.x = pk2(r[0], r[1]); o.y = pk2(r[2], r[3]); *(u32x2*)(UD + (size_t)t * 256 + c4) = o; }
    }
}

constexpr int H1_QM = 0, H1_KM = 4608, H1_KMT = 9216, H1_VT = 14336, H1_AL = 19456, H1_ST = 22016, H1_SC = 31232, H1_WAVE_LDS = 32768;
__device__ __forceinline__ void hgrn_h1_item(Frame& F, int l, int item, LAS unsigned char* ws, int lane) {
    LAUNDER_V(lane);
    const int r32 = lane & 31, hi = lane >> 5;
    const int T = item >> 3, h = (item >> 1) & 3, d = item & 1, base = T * HT;
    LAS bf16_t* QmL = (LAS bf16_t*)(ws + H1_QM); LAS bf16_t* KmL = (LAS bf16_t*)(ws + H1_KM);
    LAS float* SC = (LAS float*)(ws + H1_SC);
    float lbk = 0.f;
    if (l > 0) { const float* lg = INP(I_LBL); lbk = 1.0f / (1.0f + FEXP(lg[(0 * 2 + d) * 256 + h * 64 + lane] - lg[(1 * 2 + d) * 256 + h * 64 + lane])); }
    const float omlb = 1.0f - lbk;
    f32x16 S[2][2];
#pragma unroll
    for (int a = 0; a < 2; ++a)
#pragma unroll
        for (int b = 0; b < 2; ++b)
#pragma unroll
            for (int r = 0; r < 16; ++r) S[a][b][r] = 0.f;
    float Bprev = 0.f;
    const int fcol = (d ? ZC_FB : ZC_FF) + h * 64 + lane, qcol = ZC_Q + h * 64 + lane, vcol = ZC_I + h * 64 + lane;
    const bf16_t* Z1 = P_Z1();
    bf16_t* QSo = P_QS() + (size_t)d * M * 256; float* OL = P_OLOC() + (size_t)d * M * 256;
    for (int c = 0; c < HT / 32; ++c) {
        float bc = 0.f, bm = 0.f;
#pragma unroll 1
        for (int hf = 0; hf < 2; ++hf) {
            float b[16], kk[16]; unsigned qraw[8], vraw[8], kmrow[8];
#pragma unroll
            for (int t = 0; t < 16; ++t) { const int tau = 32 * c + 16 * hf + t, tok = base + (d ? HT - 1 - tau : tau); const unsigned ro = (unsigned)tok * NZ1;
                b[t] = bf2f(Z1[ro + fcol]); const unsigned qq = Z1[ro + qcol], vv = Z1[ro + vcol];
                if (t & 1) { qraw[t >> 1] |= qq << 16; vraw[t >> 1] |= vv << 16; } else { qraw[t >> 1] = qq; vraw[t >> 1] = vv; } }
#pragma unroll
            for (int t = 0; t < 16; ++t) { const float z = b[t], e = FEXP(-fabsf(z)), inv = 1.0f / (1.0f + e); const float sig = z >= 0.f ? inv : e * inv, nsig = z >= 0.f ? e * inv : inv;
                const float f = lbk + omlb * sig; bc += FLOG(f); b[t] = bc; kk[t] = omlb * nsig; }
            if (hf == 0) bm = bc;
#pragma unroll
            for (int t = 0; t < 16; ++t) { const float qvt = (t & 1) ? bfhi(qraw[t >> 1]) : bflo(qraw[t >> 1]); const float qm = qvt * FEXP(b[t] - bm), km = kk[t] * FEXP(bm - b[t]);
                const unsigned qb = f2bf(qm), kb = f2bf(km); const int tl = 16 * hf + t;
                QmL[tl * 72 + lane] = (bf16_t)qb; KmL[tl * 72 + lane] = (bf16_t)kb;
                if (t & 1) kmrow[t >> 1] |= kb << 16; else kmrow[t >> 1] = kb;
                const int tau = 32 * c + tl, tok = base + (d ? HT - 1 - tau : tau);
                QSo[(unsigned)tok * 256 + h * 64 + lane] = (bf16_t)f2bf(qvt * FEXP(Bprev + b[t])); }
#pragma unroll
            for (int i = 0; i < 2; ++i) { *(LAS u32x4*)(ws + H1_KMT + lane * 80 + 32 * hf + 16 * i) = (u32x4){kmrow[4 * i], kmrow[4 * i + 1], kmrow[4 * i + 2], kmrow[4 * i + 3]};
                                          *(LAS u32x4*)(ws + H1_VT + lane * 80 + 32 * hf + 16 * i) = (u32x4){vraw[4 * i], vraw[4 * i + 1], vraw[4 * i + 2], vraw[4 * i + 3]}; }
        }
        const float bt = bc;
        SC[lane] = FEXP(bm); SC[64 + lane] = FEXP(bt - bm); SC[128 + lane] = FEXP(bt);
        WAVE_SYNC();
#pragma unroll
        for (int kt = 0; kt < 2; ++kt)
#pragma unroll
            for (int vt = 0; vt < 2; ++vt)
#pragma unroll
                for (int g = 0; g < 4; ++g) { const int k0 = 32 * kt + 8 * g + 4 * hi; const f32x4 em = *(const LAS f32x4*)(SC + k0);
                    u32x2 w; w.x = pk2(S[kt][vt][4 * g] * em[0], S[kt][vt][4 * g + 1] * em[1]); w.y = pk2(S[kt][vt][4 * g + 2] * em[2], S[kt][vt][4 * g + 3] * em[3]);
                    *(LAS u32x2*)(ws + H1_ST + (32 * vt + r32) * 144 + k0 * 2) = w; }
        f32x16 at;
#pragma unroll
        for (int r = 0; r < 16; ++r) at[r] = 0.f;
#pragma unroll
        for (int ks = 0; ks < 4; ++ks) { const bf16x8 a = *(const LAS bf16x8*)(ws + H1_KM + r32 * 144 + (16 * ks + 8 * hi) * 2), bq = *(const LAS bf16x8*)(ws + H1_QM + r32 * 144 + (16 * ks + 8 * hi) * 2);
            at = MFMA32(a, bq, at); }
#pragma unroll
        for (int g = 0; g < 4; ++g) { const int s0 = 8 * g + 4 * hi; float o4[4];
#pragma unroll
            for (int i = 0; i < 4; ++i) o4[i] = (s0 + i <= r32) ? at[4 * g + i] : 0.f;
            u32x2 w; w.x = pk2(o4[0], o4[1]); w.y = pk2(o4[2], o4[3]); *(LAS u32x2*)(ws + H1_AL + r32 * 80 + s0 * 2) = w; }
        WAVE_SYNC();
#pragma unroll
        for (int vt = 0; vt < 2; ++vt) { f32x16 o;
#pragma unroll
            for (int r = 0; r < 16; ++r) o[r] = 0.f;
#pragma unroll
            for (int ks = 0; ks < 2; ++ks) { const bf16x8 a = *(const LAS bf16x8*)(ws + H1_AL + r32 * 80 + (16 * ks + 8 * hi) * 2), bv = *(const LAS bf16x8*)(ws + H1_VT + (32 * vt + r32) * 80 + (16 * ks + 8 * hi) * 2);
                o = MFMA32(a, bv, o); }
#pragma unroll
            for (int ks = 0; ks < 4; ++ks) { const bf16x8 a = *(const LAS bf16x8*)(ws + H1_QM + r32 * 144 + (16 * ks + 8 * hi) * 2), bs = *(const LAS bf16x8*)(ws + H1_ST + (32 * vt + r32) * 144 + (16 * ks + 8 * hi) * 2);
                o = MFMA32(a, bs, o); }
#pragma unroll
            for (int r = 0; r < 16; ++r) { const int tau = 32 * c + crow(r, hi), tok = base + (d ? HT - 1 - tau : tau); OL[(unsigned)tok * 256 + h * 64 + 32 * vt + r32] = o[r]; } }
#pragma unroll
        for (int kt = 0; kt < 2; ++kt)
#pragma unroll
            for (int vt = 0; vt < 2; ++vt) { f32x16 kv;
#pragma unroll
                for (int r = 0; r < 16; ++r) kv[r] = 0.f;
#pragma unroll
                for (int ks = 0; ks < 2; ++ks) { const bf16x8 a = *(const LAS bf16x8*)(ws + H1_KMT + (32 * kt + r32) * 80 + (16 * ks + 8 * hi) * 2), bv = *(const LAS bf16x8*)(ws + H1_VT + (32 * vt + r32) * 80 + (16 * ks + 8 * hi) * 2);
                    kv = MFMA32(a, bv, kv); }
#pragma unroll
                for (int g = 0; g < 4; ++g) { const int k0 = 32 * kt + 8 * g + 4 * hi; const f32x4 etm = *(const LAS f32x4*)(SC + 64 + k0), et = *(const LAS f32x4*)(SC + 128 + k0);
#pragma unroll
                    for (int i = 0; i < 4; ++i) S[kt][vt][4 * g + i] = et[i] * S[kt][vt][4 * g + i] + etm[i] * kv[4 * g + i]; } }
        Bprev += bt;
        WAVE_SYNC();
    }
    float* kvo = P_KVT() + (size_t)item * 4096;
#pragma unroll
    for (int kt = 0; kt < 2; ++kt)
#pragma unroll
        for (int vt = 0; vt < 2; ++vt)
#pragma unroll
            for (int r = 0; r < 16; ++r) kvo[(32 * kt + crow(r, hi)) * 64 + 32 * vt + r32] = S[kt][vt][r];
    P_DECT()[(size_t)item * 64 + lane] = FEXP(Bprev);
}

__device__ __forceinline__ void hgrn_h2_item(Frame& F, int l, int item, LAS unsigned char* ws, int lane) {
    LAUNDER_V(lane);
    const int r32 = lane & 31, hi = lane >> 5;
    const int T = item >> 2, h = item & 3, base = T * HT;
    int first, nt, sidx; const bool ctx = base < MC;
    if (ctx) { sidx = base / SEQ; nt = SEQ / HT; first = sidx * nt; } else { sidx = (base - MC) / LSEQ; nt = LSEQ / HT; first = MC / HT + sidx * nt; }
    const int j = T - first;
    const float* KVT = P_KVT(); const float* DECT = P_DECT();
    for (int d = 0; d < 2; ++d) {
        const int nsteps = d == 0 ? j : nt - 1 - j;
        const bool fin = ctx && ((d == 0 && j == nt - 1) || (d == 1 && j == 0));
        const size_t sbase = ((((size_t)sidx * DEPTH + l) * 2 + d) * 4 + h) * 4096;
        LAS bf16_t* ST = (LAS bf16_t*)(ws + d * 9216);
        for (int q4 = 0; q4 < 4; ++q4) {
            f32x4 S4[4];
#pragma unroll
            for (int i = 0; i < 4; ++i) { const int e = (q4 * 4 + i) * 64 + lane; if (ctx) S4[i] = (f32x4){0.f, 0.f, 0.f, 0.f}; else S4[i] = *(const f32x4*)(INP(I_STATE) + sbase + (size_t)e * 4); }
            for (int s = 0; s < nsteps; ++s) { const int jj = d == 0 ? s : nt - 1 - s; const size_t it = ((size_t)(first + jj) * 4 + h) * 2 + d;
                const float* kv = KVT + it * 4096; const float* dc = DECT + it * 64;
#pragma unroll
                for (int i = 0; i < 4; ++i) { const int e = (q4 * 4 + i) * 64 + lane; const float dk = dc[e >> 4]; S4[i] = S4[i] * dk + *(const f32x4*)(kv + (size_t)e * 4); } }
            if (fin) { const size_t it = ((size_t)T * 4 + h) * 2 + d; const float* kv = KVT + it * 4096; const float* dc = DECT + it * 64; float* ns = P_NS() + sbase;
#pragma unroll
                for (int i = 0; i < 4; ++i) { const int e = (q4 * 4 + i) * 64 + lane; *(f32x4*)(ns + (size_t)e * 4) = S4[i] * dc[e >> 4] + *(const f32x4*)(kv + (size_t)e * 4); } }
#pragma unroll
            for (int i = 0; i < 4; ++i) { const int e = (q4 * 4 + i) * 64 + lane, k = e >> 4, v0 = (e & 15) * 4;
#pragma unroll
                for (int q = 0; q < 4; ++q) ST[(v0 + q) * 72 + k] = (bf16_t)f2bf(S4[i][q]); }
        }
    }
    WAVE_SYNC();
    const float* ng = INP(I_HNG) + (size_t)l * 256 + h * 64;
    const bf16_t* QS = P_QS(); const float* OLOC = P_OLOC(); const bf16_t* Z1 = P_Z1(); bf16_t* UB = P_U(1);
    for (int cc = 0; cc < HT / 32; ++cc) {
        CFENCE();
        f32x16 o[2];
#pragma unroll
        for (int vt = 0; vt < 2; ++vt) {
#pragma unroll
            for (int r = 0; r < 16; ++r) o[vt][r] = 0.f;
#pragma unroll
            for (int d = 0; d < 2; ++d)
#pragma unroll
                for (int ks = 0; ks < 4; ++ks) { const bf16x8 a = *(const bf16x8*)(QS + (size_t)d * M * 256 + (size_t)(base + 32 * cc + r32) * 256 + h * 64 + 16 * ks + 8 * hi);
                    const bf16x8 bs = *(const LAS bf16x8*)(ws + d * 9216 + (32 * vt + r32) * 144 + (16 * ks + 8 * hi) * 2); o[vt] = MFMA32(a, bs, o[vt]); }
#pragma unroll
            for (int r = 0; r < 16; ++r) { const size_t idx = (size_t)(base + 32 * cc + crow(r, hi)) * 256 + h * 64 + 32 * vt + r32; o[vt][r] += OLOC[idx] + OLOC[(size_t)M * 256 + idx]; } }
#pragma unroll
        for (int r = 0; r < 16; ++r) { float ss = o[0][r] * o[0][r] + o[1][r] * o[1][r];
            ss += SHFL_XOR(ss, 1, lane); ss += SHFL_XOR(ss, 2, lane); ss += SHFL_XOR(ss, 4, lane); ss += SHFL_XOR(ss, 8, lane); ss += SHFL_XOR(ss, 16, lane);
            const float rs = FRSQ(ss * (1.f / 64.f) + EPS); const int tok = base + 32 * cc + crow(r, hi);
#pragma unroll
            for (int vt = 0; vt < 2; ++vt) { const int col = h * 64 + 32 * vt + r32; const float go = bf2f(Z1[(size_t)tok * NZ1 + ZC_GO + col]);
                UB[(size_t)tok * 256 + col] = (bf16_t)f2bf(o[vt][r] * rs * ng[32 * vt + r32] * siluf_(go)); } }
    }
    WAVE_SYNC();
}

#ifndef PMASK
#define PMASK 0xFFFF
#endif
#define PM(b) ((PMASK >> (b)) & 1)
__global__ void __launch_bounds__(NTHR, 2) fwd_kernel(Args args) {
#ifdef EMU
    unsigned char* lds = emu_lds;
#else
    extern __shared__ __attribute__((aligned(16))) unsigned char lds[];
#endif
    Frame F;
    F.lds = (LAS unsigned char*)lds;
#ifdef EMU
    F.ap = &args;
#else
    F.ap = (ArgsP)__builtin_amdgcn_kernarg_segment_ptr();
#endif
    F.G = gridDim.x; F.bid = blockIdx.x;
    const int lo = F.ap->ph_lo, hi = F.ap->ph_hi;
#ifndef EMU
    volatile LAS unsigned* MISC = (volatile LAS unsigned*)(F.lds + MISC_OFF);
    if (threadIdx.x < 32) MISC[threadIdx.x] = 0u;
    __syncthreads();
    if (threadIdx.x == 0) (void)xb_add((unsigned*)WSB(WS_CTL) + CW_BAR + XB_XCNT(xb_xcc_id()), 1u);
#define GRID_BAR() do { LAUNDER(F.ap); xcd_barrier((unsigned*)WSB(WS_CTL) + CW_BAR, MISC + 8); } while (0)
#else
#define GRID_BAR() do { } while (0)
#endif
#define IN(k) (lo <= (k) && (k) < hi)
#define SEAM(k) do { if (IN(k) && IN((k) + 1)) GRID_BAR(); } while (0)

    if (IN(PH_PRO)) { if (PM(0)) p_mod(F); BLOCK_SYNC(); if (PM(1)) p_convert(F, 0); }
    SEAM(PH_PRO);
    for (int l = 0; l < DEPTH; ++l) {
        const int P0 = 1 + PH_PER_LAYER * l;
        if (IN(P0 + LP_CONV)) { if (PM(1)) if (l > 0) p_convert(F, l); }
        if (l > 0) SEAM(P0 + LP_CONV);
        if (PM(2)) if (IN(P0 + LP_NORMA)) p_norm(F, l, false, l == 0);
        SEAM(P0 + LP_NORMA);
        if (PM(3)) if (IN(P0 + LP_Z1)) { LAUNDER(F.ap); pg8::Gemm g{P_HB(), (bf16_t*)WSB(WS_WB + WB_WIN1), M, NZ1, D, 30, 0}; pg8::StaticOrder S; S.init(M, NZ1, F.G, F.bid);
            pg8::EpiStoreBf16 E{P_Z1(), NZ1}; pg8::gemm_phase<pg8::EpiStoreBf16, pg8::StaticOrder, true, true>(F.lds, g, S, E); }
        SEAM(P0 + LP_Z1);
        if (IN(P0 + LP_MIX)) {
            if (PM(4)) p_mixA(F, l);
            LAUNDER(F.ap); PHASE_IDS();
            if (wave_ < 4) { if (PM(5)) { for (int it = F.bid * 4 + wave_; it < (M / HT) * 8; it += F.G * 4) hgrn_h1_item(F, l, it, F.lds + wave_ * H1_WAVE_LDS, lane_); } }
            else { if (PM(6)) p_mixCD(F, l, F.bid * 4 + (wave_ - 4), F.G * 4); }
        }
        SEAM(P0 + LP_MIX);
        if (PM(7)) if (IN(P0 + LP_H2)) { LAUNDER(F.ap); PHASE_IDS(); if (wave_ < 4) { for (int it = F.bid * 4 + wave_; it < (M / HT) * 4; it += F.G * 4) hgrn_h2_item(F, l, it, F.lds + wave_ * H1_WAVE_LDS, lane_); } }
        SEAM(P0 + LP_H2);
        if (PM(8)) if (IN(P0 + LP_Y)) { LAUNDER(F.ap); pg8::Gemm g{P_U(0), (bf16_t*)WSB(WS_WB + WB_WOUT), M, 4096, 256, 2, (size_t)M * 256 * 2}; pg8::StaticOrder S; S.init(M, 4096, F.G, F.bid);
            pg8::EpiStoreBf16 E{(bf16_t*)WSB(WS_BIG), 4096}; pg8::gemm_phase<pg8::EpiStoreBf16, pg8::StaticOrder, true, true>(F.lds, g, S, E); }
        SEAM(P0 + LP_Y);
        if (PM(9)) if (IN(P0 + LP_MERGE)) { LAUNDER(F.ap); pg8::Gemm g{P_HB(), (bf16_t*)WSB(WS_WB + WB_WG), M, 4096, D, 30, 0}; pg8::StaticOrder S; S.init(M, 4096, F.G, F.bid);
            pg8::EpiMerge E{(const bf16_t*)WSB(WS_BIG), (bf16_t*)WSB(WS_U)}; pg8::gemm_phase<pg8::EpiMerge, pg8::StaticOrder, true, true>(F.lds, g, S, E); }
        SEAM(P0 + LP_MERGE);
        if (PM(10)) if (IN(P0 + LP_WO)) { LAUNDER(F.ap); pg8::Gemm g{(bf16_t*)WSB(WS_U), (bf16_t*)WSB(WS_WB + WB_WO), M, D, D, 30, 0}; pg8::StaticOrder S; S.init(M, D, F.G, F.bid);
            pg8::EpiResid E{P_X(), P_MOD() + (size_t)l * NGRP * NMOD + 2 * D}; pg8::gemm_phase<pg8::EpiResid, pg8::StaticOrder, true, true>(F.lds, g, S, E); }
        SEAM(P0 + LP_WO);
        if (PM(2)) if (IN(P0 + LP_NORMF)) p_norm(F, l, true, false);
        SEAM(P0 + LP_NORMF);
        if (PM(11)) if (IN(P0 + LP_W13)) { LAUNDER(F.ap); pg8::Gemm g{P_HB(), (bf16_t*)WSB(WS_WB + WB_W13), M, 2 * DFF, D, 30, 0}; pg8::StaticOrder S; S.init(M, 2 * DFF, F.G, F.bid);
            pg8::EpiSwiglu E{(bf16_t*)WSB(WS_BIG), DFF}; pg8::gemm_phase<pg8::EpiSwiglu, pg8::StaticOrder, true, true>(F.lds, g, S, E); }
        SEAM(P0 + LP_W13);
        if (PM(12)) if (IN(P0 + LP_W2)) { LAUNDER(F.ap); pg8::Gemm g{(bf16_t*)WSB(WS_BIG), (bf16_t*)WSB(WS_WB + WB_W2), M, D, DFF, 30, 0}; pg8::StaticOrder S; S.init(M, D, F.G, F.bid);
            pg8::EpiResid E{P_X(), P_MOD() + (size_t)l * NGRP * NMOD + 5 * D}; pg8::gemm_phase<pg8::EpiResid, pg8::StaticOrder, true, true>(F.lds, g, S, E); }
        SEAM(P0 + LP_W2);
    }
    if (PM(13)) if (IN(PH_FINAL)) p_final(F);
}

#ifndef EMU
extern "C" void kernel_launch(void* const* d_in, const int* in_sizes, int n_in, void* d_out, int out_size, void* d_ws, size_t ws_size, hipStream_t stream) {
    static int grid = 0;
    if (grid == 0) {
        if (n_in != 26 || in_sizes[0] != MC * D || out_size != M * D + CB * DEPTH * 2 * 4 * 4096 || ws_size < WS_END) { fprintf(stderr, "kernel_launch: unexpected shapes (n_in %d in0 %d out %d ws %zu)\n", n_in, n_in > 0 ? in_sizes[0] : -1, out_size, ws_size); grid = -1; return; }
        int dev = 0, cus = 0;
        if (hipGetDevice(&dev) != hipSuccess || hipDeviceGetAttribute(&cus, hipDeviceAttributeMultiprocessorCount, dev) != hipSuccess) { grid = -1; return; }
        if (hipFuncSetAttribute((const void*)fwd_kernel, hipFuncAttributeMaxDynamicSharedMemorySize, LDS_BYTES) != hipSuccess) { fprintf(stderr, "kernel_launch: hipFuncSetAttribute failed\n"); grid = -1; return; }
        int per_cu = 0;
        if (hipOccupancyMaxActiveBlocksPerMultiprocessor(&per_cu, (const void*)fwd_kernel, NTHR, LDS_BYTES) != hipSuccess || per_cu < 1) fprintf(stderr, "kernel_launch: occupancy query reports %d\n", per_cu);
        (void)hipGetLastError();
        grid = cus;
    }
    if (grid < 0) return;
    (void)hipMemsetAsync((char*)d_ws + WS_CTL, 0, CTL_ZERO_BYTES, stream);
    Args a{};
    for (int i = 0; i < 26; ++i) a.in[i] = (const float*)d_in[i];
    a.out = (float*)d_out; a.ws = (unsigned char*)d_ws; a.ph_lo = 0; a.ph_hi = N_PHASES;
    hipLaunchKernelGGL(fwd_kernel, dim3(grid), dim3(NTHR), LDS_BYTES, stream, a);
}
#endif
```
